# Optimizing an MI355X kernel written in HIP

```python
import math
import jax, jax.numpy as jnp
from jax import lax
import numpy as np

D_MODEL = 1024
BATCH = 4
SEQ = 4096
DEPTH = 1
DEC_BATCH = 1
DEC_SEQ = 16384
PAST_LEN = 128

CONV_WIDTH = D_MODEL // 2
CONV_HEADS = 8
CONV_K = 3
POOL_WINDOWS = (2, 4, 8, 16)
N_POOL_GROUPS = len(POOL_WINDOWS)
POOL_WIDTH = D_MODEL - CONV_WIDTH
POOL_GROUP = POOL_WIDTH // N_POOL_GROUPS
PROJ_WIDTH = 3 * CONV_WIDTH + POOL_WIDTH
D_FF = 4 * D_MODEL
LN_EPS = 1e-5
DEEPNORM_ALPHA = (2.0 * DEPTH) ** 0.25
DEEPNORM_BETA = (8.0 * DEPTH) ** -0.25

kernel_name = "hybrid_conv_pool_encoder"


def layer_norm(x, g, b):
    xf = x.astype(jnp.float32)
    mu = jnp.mean(xf, axis=-1, keepdims=True)
    var = jnp.mean(jnp.square(xf - mu), axis=-1, keepdims=True)
    y = (xf - mu) * lax.rsqrt(var + LN_EPS) * g.astype(jnp.float32) + b.astype(jnp.float32)
    return y.astype(x.dtype)


def centred_short_conv(u, w):
    up = jnp.pad(u, ((0, 0), (1, 1), (0, 0)))
    return up[:, :-2] * w[0] + up[:, 1:-1] * w[1] + up[:, 2:] * w[2]


def multiscale_pool(u, pool_w, pool_scale):
    bsz, s, _ = u.shape
    ug = u.reshape(bsz, s, N_POOL_GROUPS, POOL_GROUP)
    t = jnp.arange(s, dtype=jnp.int32)
    outs = []
    for i, w in enumerate(POOL_WINDOWS):
        xg = ug[:, :, i, :].astype(jnp.float32)
        cs = jnp.concatenate([jnp.zeros((bsz, 1, POOL_GROUP), jnp.float32),
                              jnp.cumsum(xg, axis=1)], axis=1)
        lo = jnp.clip(t - w // 2, 0, s)
        hi = jnp.clip(t + w - w // 2, 0, s)
        win_sum = jnp.take(cs, hi, axis=1) - jnp.take(cs, lo, axis=1)
        cnt = (hi - lo).astype(jnp.float32)[None, :, None]
        outs.append(win_sum / cnt - xg)
    pooled = jnp.stack(outs, axis=2).astype(u.dtype)
    mixed = jnp.einsum('bsgc,gcd->bsgd', pooled, pool_w)
    return mixed.reshape(bsz, s, POOL_WIDTH) * pool_scale


def encoder_layer(x, w_in, conv_w, pool_w, pool_scale, w_out, ln1_g, ln1_b, w_ff1, w_ff2, ln2_g, ln2_b):
    proj = jnp.einsum('bsd,dp->bsp', x, w_in)
    gate_b = proj[..., :CONV_WIDTH]
    gate_c = proj[..., CONV_WIDTH:2 * CONV_WIDTH]
    value = proj[..., 2 * CONV_WIDTH:3 * CONV_WIDTH]
    pool_in = proj[..., 3 * CONV_WIDTH:]
    y_conv = gate_b * centred_short_conv(gate_c * value, conv_w)
    y_pool = multiscale_pool(pool_in, pool_w, pool_scale)
    mix = jnp.einsum('bsc,cd->bsd', jnp.concatenate([y_conv, y_pool], axis=-1), w_out)
    x = layer_norm(DEEPNORM_ALPHA * x + mix, ln1_g, ln1_b)
    h = jnp.square(jax.nn.relu(jnp.einsum('bsd,df->bsf', x, w_ff1)))
    ff = jnp.einsum('bsf,fd->bsd', h, w_ff2)
    return layer_norm(DEEPNORM_ALPHA * x + ff, ln2_g, ln2_b)


def setup_inputs(seed: int = 0) -> dict:
    key = jax.random.key(seed)
    ks = jax.random.split(key, 16)
    f32 = jnp.float32
    x_prompt = jax.random.normal(ks[0], (BATCH, SEQ, D_MODEL), f32)
    x_sample = jax.random.normal(ks[1], (DEC_BATCH, DEC_SEQ, D_MODEL), f32)
    col_scale = jnp.concatenate([jnp.ones((2 * CONV_WIDTH,), f32),
                                 jnp.full((CONV_WIDTH + POOL_WIDTH,), DEEPNORM_BETA, f32)])
    w_in = jax.random.normal(ks[2], (DEPTH, D_MODEL, PROJ_WIDTH), f32) * (D_MODEL ** -0.5) * col_scale
    conv_w = jax.random.normal(ks[3], (DEPTH, CONV_K, CONV_WIDTH), f32) * (CONV_K ** -0.5)
    pool_w = jax.random.normal(ks[4], (DEPTH, N_POOL_GROUPS, POOL_GROUP, POOL_GROUP), f32) * (POOL_GROUP ** -0.5)
    pool_scale = 1.0 + 0.1 * jax.random.normal(ks[5], (DEPTH, POOL_WIDTH), f32)
    w_out = jax.random.normal(ks[6], (DEPTH, D_MODEL, D_MODEL), f32) * (D_MODEL ** -0.5) * DEEPNORM_BETA
    ln1_g = 1.0 + 0.02 * jax.random.normal(ks[7], (DEPTH, D_MODEL), f32)
    ln1_b = 0.02 * jax.random.normal(ks[8], (DEPTH, D_MODEL), f32)
    w_ff1 = jax.random.normal(ks[9], (DEPTH, D_MODEL, D_FF), f32) * (D_MODEL ** -0.5) * DEEPNORM_BETA
    w_ff2 = jax.random.normal(ks[10], (DEPTH, D_FF, D_MODEL), f32) * (D_FF ** -0.5) * DEEPNORM_BETA
    ln2_g = 1.0 + 0.02 * jax.random.normal(ks[11], (DEPTH, D_MODEL), f32)
    ln2_b = 0.02 * jax.random.normal(ks[12], (DEPTH, D_MODEL), f32)
    return {"x_prompt": x_prompt, "x_sample": x_sample, "w_in": w_in, "conv_w": conv_w,
            "pool_w": pool_w, "pool_scale": pool_scale, "w_out": w_out, "ln1_g": ln1_g,
            "ln1_b": ln1_b, "w_ff1": w_ff1, "w_ff2": w_ff2, "ln2_g": ln2_g, "ln2_b": ln2_b}


def reference(x_prompt, x_sample, w_in, conv_w, pool_w, pool_scale, w_out, ln1_g, ln1_b,
              w_ff1, w_ff2, ln2_g, ln2_b):
    y_prompt = x_prompt
    y_sample = x_sample
    for l in range(DEPTH):
        p = (w_in[l], conv_w[l], pool_w[l], pool_scale[l], w_out[l], ln1_g[l], ln1_b[l],
             w_ff1[l], w_ff2[l], ln2_g[l], ln2_b[l])
        y_prompt = encoder_layer(y_prompt, *p)
        y_sample = encoder_layer(y_sample, *p)
    return (y_prompt, y_sample)
```

```cpp
#include <hip/hip_runtime.h>
#include <cstdio>
#include <cstdint>

namespace {
constexpr int D = 1024, CW = 512, PW = 2048, FF = 4096, PG = 128;
constexpr float ALPHA = 1.189207115002721f, LN_EPS = 1e-5f;

template <int ACT>
__global__ void __launch_bounds__(256) gemm_f32(const float* __restrict__ A, int lda, const float* __restrict__ B, int ldb, float* __restrict__ C, int ldc, int K) {
    __shared__ float As[16][64 + 4];
    __shared__ float Bs[16][64 + 4];
    const int tx = threadIdx.x & 15, ty = threadIdx.x >> 4;
    const int m0 = blockIdx.y * 64, n0 = blockIdx.x * 64;
    float acc[4][4] = {};
    for (int k0 = 0; k0 < K; k0 += 16) {
        for (int i = threadIdx.x; i < 64 * 16; i += 256) { const int r = i >> 4, c = i & 15; As[c][r] = A[(size_t)(m0 + r) * lda + k0 + c]; }
        for (int i = threadIdx.x; i < 16 * 64; i += 256) { const int r = i >> 6, c = i & 63; Bs[r][c] = B[(size_t)(k0 + r) * ldb + n0 + c]; }
        __syncthreads();
#pragma unroll
        for (int k = 0; k < 16; ++k) {
            float a[4], b[4];
#pragma unroll
            for (int i = 0; i < 4; ++i) { a[i] = As[k][ty * 4 + i]; b[i] = Bs[k][tx * 4 + i]; }
#pragma unroll
            for (int i = 0; i < 4; ++i)
#pragma unroll
                for (int j = 0; j < 4; ++j) acc[i][j] += a[i] * b[j];
        }
        __syncthreads();
    }
#pragma unroll
    for (int i = 0; i < 4; ++i)
#pragma unroll
        for (int j = 0; j < 4; ++j) { float v = acc[i][j]; if (ACT == 1) { v = v > 0.f ? v : 0.f; v = v * v; } C[(size_t)(m0 + ty * 4 + i) * ldc + n0 + tx * 4 + j] = v; }
}

__global__ void __launch_bounds__(256) mix_pre(const float* __restrict__ proj, const float* __restrict__ conv_w, float* __restrict__ y, int S) {
    const int row = blockIdx.x, t = row % S;
    const float* p = proj + (size_t)row * PW;
    for (int c = threadIdx.x; c < D; c += 256) {
        float out;
        if (c < CW) {
            const float u0 = p[CW + c] * p[2 * CW + c];
            const float um = t > 0 ? p[-PW + CW + c] * p[-PW + 2 * CW + c] : 0.f;
            const float up = t < S - 1 ? p[PW + CW + c] * p[PW + 2 * CW + c] : 0.f;
            out = p[c] * (um * conv_w[c] + u0 * conv_w[CW + c] + up * conv_w[2 * CW + c]);
        } else {
            const int ch = c - CW, g = ch / PG, w = 2 << g;
            int lo = t - w / 2, hi = t + w - w / 2; lo = lo < 0 ? 0 : lo; hi = hi > S ? S : hi;
            float s = 0.f;
            for (int j = lo; j < hi; ++j) s += p[(ptrdiff_t)(j - t) * PW + 3 * CW + ch];
            out = s / (float)(hi - lo) - p[3 * CW + ch];
        }
        y[(size_t)row * D + c] = out;
    }
}
__global__ void __launch_bounds__(256) pool_mix(const float* __restrict__ y, const float* __restrict__ pool_w, const float* __restrict__ pool_scale, float* __restrict__ y2) {
    __shared__ float pin[512];
    const int row = blockIdx.x;
    for (int c = threadIdx.x; c < 512; c += 256) { pin[c] = y[(size_t)row * D + CW + c]; y2[(size_t)row * D + c] = y[(size_t)row * D + c]; }
    __syncthreads();
    for (int o = threadIdx.x; o < 512; o += 256) {
        const int g = o / PG, d = o % PG; float s = 0.f;
        for (int c = 0; c < PG; ++c) s += pin[g * PG + c] * pool_w[((size_t)g * PG + c) * PG + d];
        y2[(size_t)row * D + CW + o] = s * pool_scale[o];
    }
}
__global__ void __launch_bounds__(256) ln_res(const float* res, const float* __restrict__ add, const float* __restrict__ g, const float* __restrict__ b, float* out) {
    __shared__ float red[8];
    const int row = blockIdx.x, tid = threadIdx.x;
    float v[4]; float s = 0.f;
#pragma unroll
    for (int i = 0; i < 4; ++i) { const int c = tid + 256 * i; v[i] = ALPHA * res[(size_t)row * D + c] + add[(size_t)row * D + c]; s += v[i]; }
    for (int o = 32; o > 0; o >>= 1) s += __shfl_xor(s, o);
    if ((tid & 63) == 0) red[tid >> 6] = s;
    __syncthreads();
    const float mean = (red[0] + red[1] + red[2] + red[3]) * (1.f / D);
    float q = 0.f;
#pragma unroll
    for (int i = 0; i < 4; ++i) { v[i] -= mean; q += v[i] * v[i]; }
    for (int o = 32; o > 0; o >>= 1) q += __shfl_xor(q, o);
    if ((tid & 63) == 0) red[4 + (tid >> 6)] = q;
    __syncthreads();
    const float rstd = 1.0f / sqrtf((red[4] + red[5] + red[6] + red[7]) * (1.f / D) + LN_EPS);
#pragma unroll
    for (int i = 0; i < 4; ++i) { const int c = tid + 256 * i; out[(size_t)row * D + c] = v[i] * rstd * g[c] + b[c]; }
}
}

extern "C" void kernel_launch(void* const* d_in, const int* in_sizes, int n_in, void* d_out, int out_size, void* d_ws, size_t ws_size, hipStream_t stream) {
    const float* xs[2] = {(const float*)d_in[0], (const float*)d_in[1]};
    const float *w_in = (const float*)d_in[2], *conv_w = (const float*)d_in[3], *pool_w = (const float*)d_in[4], *pool_scale = (const float*)d_in[5], *w_out = (const float*)d_in[6];
    const float *ln1_g = (const float*)d_in[7], *ln1_b = (const float*)d_in[8], *w_ff1 = (const float*)d_in[9], *w_ff2 = (const float*)d_in[10], *ln2_g = (const float*)d_in[11], *ln2_b = (const float*)d_in[12];
    const size_t MiB = 1u << 20;
    char* ws = (char*)d_ws;
    const int MH = 16384, seqlen[2] = {4096, 16384};
    for (int h = 0; h < 2; ++h) {
        const float* x = xs[h]; float* out = (float*)d_out + (size_t)h * MH * D;
        float* proj = (float*)(ws);
        float* y = (float*)(ws + 128 * MiB);
        float* y2 = (float*)(ws + 192 * MiB);
        gemm_f32<0><<<dim3(PW / 64, MH / 64), 256, 0, stream>>>(x, D, w_in, PW, proj, PW, D);
        mix_pre<<<MH, 256, 0, stream>>>(proj, conv_w, y, seqlen[h]);
        pool_mix<<<MH, 256, 0, stream>>>(y, pool_w, pool_scale, y2);
        float* mix = y;
        gemm_f32<0><<<dim3(D / 64, MH / 64), 256, 0, stream>>>(y2, D, w_out, D, mix, D, D);
        ln_res<<<MH, 256, 0, stream>>>(x, mix, ln1_g, ln1_b, out);
        for (int c = 0; c < 4; ++c) {
            float* x1 = out + (size_t)c * 4096 * D;
            float* hb = (float*)ws;
            float* ff = (float*)(ws + 64 * MiB);
            gemm_f32<1><<<dim3(FF / 64, 4096 / 64), 256, 0, stream>>>(x1, D, w_ff1, FF, hb, FF, D);
            gemm_f32<0><<<dim3(D / 64, 4096 / 64), 256, 0, stream>>>(hb, FF, w_ff2, D, ff, D, FF);
            ln_res<<<4096, 256, 0, stream>>>(x1, ff, ln2_g, ln2_b, x1);
        }
    }
}
```
